# Optimizing an MI355X kernel written in HIP

```python
import math, functools
import jax, jax.numpy as jnp
from jax import lax
import numpy as np

D_MODEL = 1024
BATCH = 32
SEQ = 2048
DEPTH = 1

EPS = 1e-6
D_FF = 2816
MIX_WIDTH = D_MODEL
POOL_WIDTH = MIX_WIDTH // 2
N_POOL_GROUPS = 4
POOL_GROUP_DIM = POOL_WIDTH // N_POOL_GROUPS
POOL_WINDOWS = (2, 4, 8, 16)
ATTN_WIDTH = MIX_WIDTH // 2
N_HEADS = 8
HEAD_DIM = ATTN_WIDTH // N_HEADS
MOBA_BLOCK = 256
MOBA_TOPK = 3
Q_BLOCK = 128
N_BRANCHES = 2
IN_WIDTH = POOL_WIDTH + 3 * ATTN_WIDTH + N_BRANCHES * D_MODEL

kernel_name = "hybrid_pool_moba_gated_macaron"


def rms_norm(x, g):
    xf = x.astype(jnp.float32)
    y = xf * lax.rsqrt(jnp.mean(xf * xf, axis=-1, keepdims=True) + EPS)
    return (y * g.astype(jnp.float32)).astype(x.dtype)


def swiglu(x, w_gate, w_up, w_down):
    return (jax.nn.silu(x @ w_gate) * (x @ w_up)) @ w_down


def alibi_slopes(n_heads):
    return jnp.exp2(-8.0 * jnp.arange(1, n_heads + 1, dtype=jnp.float32) / n_heads)


def multiscale_pool(u, w_pool, pool_scale):
    B, S, _ = u.shape
    ug = u.reshape(B, S, N_POOL_GROUPS, POOL_GROUP_DIM)
    csum = jnp.cumsum(ug.astype(jnp.float32), axis=1)
    csum = jnp.pad(csum, ((0, 0), (1, 0), (0, 0), (0, 0)))
    t = jnp.arange(S)
    pooled = []
    for g, w in enumerate(POOL_WINDOWS):
        lo = jnp.maximum(t + 1 - w, 0)
        win_sum = csum[:, 1:, g] - csum[:, lo, g]
        count = (t + 1 - lo).astype(jnp.float32)
        pooled.append(win_sum / count[None, :, None])
    pooled = jnp.stack(pooled, axis=2)
    mixed = (pooled - ug.astype(jnp.float32)).astype(u.dtype)
    y = jnp.einsum('bsgc,gcd->bsgd', mixed, w_pool).reshape(B, S, POOL_WIDTH)
    return y * pool_scale


def moba_attention(q, k, v, slopes):
    B, S, H, Dh = q.shape
    BS = MOBA_BLOCK
    nb = -(-S // BS)
    pad = nb * BS - S
    qh = q.transpose(0, 2, 1, 3)
    kh = jnp.pad(k.transpose(0, 2, 1, 3), ((0, 0), (0, 0), (0, pad), (0, 0)))
    vh = jnp.pad(v.transpose(0, 2, 1, 3), ((0, 0), (0, 0), (0, pad), (0, 0)))
    kb = kh.reshape(B, H, nb, BS, Dh)
    vb = vh.reshape(B, H, nb, BS, Dh)

    t_all = jnp.arange(S)
    k_mean = jnp.mean(kb.astype(jnp.float32), axis=3)
    gate = jnp.einsum('bhsd,bhnd->bhsn', qh.astype(jnp.float32), k_mean)
    fully_past = jnp.arange(nb)[None, :] < (t_all // BS)[:, None]
    gate = jnp.where(fully_past[None, None], gate, -jnp.inf)
    topk = min(MOBA_TOPK, nb)
    _, sel_idx = lax.top_k(gate, topk)

    nqb = S // Q_BLOCK
    q_blocks = qh.reshape(B, H, nqb, Q_BLOCK, Dh).transpose(0, 2, 1, 3, 4).reshape(B * nqb, H, Q_BLOCK, Dh)
    idx_blocks = sel_idx.reshape(B, H, nqb, Q_BLOCK, topk).transpose(0, 2, 1, 3, 4).reshape(B * nqb, H, Q_BLOCK, topk)
    b_ids = jnp.repeat(jnp.arange(B), nqb)
    qb_ids = jnp.tile(jnp.arange(nqb), B)
    scale = Dh ** -0.5
    head_ix = jnp.arange(H)[:, None, None]
    pos_in_blk = jnp.arange(BS)

    def one_query_block(args):
        b, qi, qblk, idx = args
        kb_b = kb[b]
        vb_b = vb[b]
        tq = qi * Q_BLOCK + jnp.arange(Q_BLOCK)
        own = (qi * Q_BLOCK) // BS
        k_own = lax.dynamic_index_in_dim(kb_b, own, axis=1, keepdims=False)
        v_own = lax.dynamic_index_in_dim(vb_b, own, axis=1, keepdims=False)
        s_own = own * BS + pos_in_blk
        k_sel = kb_b[head_ix, idx]
        v_sel = vb_b[head_ix, idx]
        s_sel = idx[..., None] * BS + pos_in_blk
        slot_ok = jnp.arange(topk)[None, :] < (tq // BS)[:, None]

        l_sel = (jnp.einsum('hqd,hqjsd->hqjs', qblk, k_sel).astype(jnp.float32) * scale
                 - slopes[:, None, None, None] * (tq[None, :, None, None] - s_sel).astype(jnp.float32))
        l_sel = jnp.where(slot_ok[None, :, :, None], l_sel, -jnp.inf)
        l_own = (jnp.einsum('hqd,hsd->hqs', qblk, k_own).astype(jnp.float32) * scale
                 - slopes[:, None, None] * (tq[:, None] - s_own[None, :]).astype(jnp.float32))
        l_own = jnp.where((s_own[None, :] <= tq[:, None])[None], l_own, -jnp.inf)

        logits = jnp.concatenate([l_sel.reshape(H, Q_BLOCK, topk * BS), l_own], axis=-1)
        p = jax.nn.softmax(logits, axis=-1).astype(v.dtype)
        p_sel = p[..., :topk * BS].reshape(H, Q_BLOCK, topk, BS)
        p_own = p[..., topk * BS:]
        return (jnp.einsum('hqjs,hqjsd->hqd', p_sel, v_sel)
                + jnp.einsum('hqs,hsd->hqd', p_own, v_own))

    out = lax.map(one_query_block, (b_ids, qb_ids, q_blocks, idx_blocks))
    return out.reshape(B, nqb, H, Q_BLOCK, Dh).transpose(0, 1, 3, 2, 4).reshape(B, S, H * Dh)


def setup_inputs(seed: int = 0) -> dict:
    key = jax.random.key(seed)
    ks = jax.random.split(key, 17)
    L = DEPTH
    f32 = jnp.float32

    def w(k, shape, fan_in):
        return jax.random.normal(k, shape, f32) * fan_in ** -0.5

    def gain(k, shape):
        return 1.0 + 0.1 * jax.random.normal(k, shape, f32)

    return {
        "x": jax.random.normal(ks[0], (BATCH, SEQ, D_MODEL), f32),
        "ffn1_norm": gain(ks[1], (L, D_MODEL)),
        "ffn1_w_gate": w(ks[2], (L, D_MODEL, D_FF), D_MODEL),
        "ffn1_w_up": w(ks[3], (L, D_MODEL, D_FF), D_MODEL),
        "ffn1_w_down": w(ks[4], (L, D_FF, D_MODEL), D_FF),
        "mix_norm": gain(ks[5], (L, D_MODEL)),
        "w_in": w(ks[6], (L, D_MODEL, IN_WIDTH), D_MODEL),
        "pool_w": w(ks[7], (L, N_POOL_GROUPS, POOL_GROUP_DIM, POOL_GROUP_DIM), POOL_GROUP_DIM),
        "pool_scale": gain(ks[8], (L, POOL_WIDTH)),
        "w_branch_pool": w(ks[9], (L, POOL_WIDTH, D_MODEL), POOL_WIDTH),
        "w_branch_attn": w(ks[10], (L, ATTN_WIDTH, D_MODEL), ATTN_WIDTH),
        "w_out": w(ks[11], (L, D_MODEL, D_MODEL), D_MODEL),
        "ffn2_norm": gain(ks[12], (L, D_MODEL)),
        "ffn2_w_gate": w(ks[13], (L, D_MODEL, D_FF), D_MODEL),
        "ffn2_w_up": w(ks[14], (L, D_MODEL, D_FF), D_MODEL),
        "ffn2_w_down": w(ks[15], (L, D_FF, D_MODEL), D_FF),
        "final_norm": gain(ks[16], (D_MODEL,)),
    }


def reference(x, ffn1_norm, ffn1_w_gate, ffn1_w_up, ffn1_w_down, mix_norm, w_in,
              pool_w, pool_scale, w_branch_pool, w_branch_attn, w_out,
              ffn2_norm, ffn2_w_gate, ffn2_w_up, ffn2_w_down, final_norm):
    B, S, _ = x.shape
    slopes = alibi_slopes(N_HEADS)
    h = x
    for l in range(DEPTH):
        h = h + 0.5 * swiglu(rms_norm(h, ffn1_norm[l]), ffn1_w_gate[l], ffn1_w_up[l], ffn1_w_down[l])

        u = rms_norm(h, mix_norm[l])
        proj = u @ w_in[l]
        o1 = POOL_WIDTH
        o2 = o1 + ATTN_WIDTH
        o3 = o2 + ATTN_WIDTH
        o4 = o3 + ATTN_WIDTH
        u_pool = proj[..., :o1]
        q = proj[..., o1:o2].reshape(B, S, N_HEADS, HEAD_DIM)
        k = proj[..., o2:o3].reshape(B, S, N_HEADS, HEAD_DIM)
        v = proj[..., o3:o4].reshape(B, S, N_HEADS, HEAD_DIM)
        gates = jax.nn.sigmoid(proj[..., o4:].astype(jnp.float32)).astype(h.dtype)
        gates = gates.reshape(B, S, N_BRANCHES, D_MODEL)

        y_pool = multiscale_pool(u_pool, pool_w[l], pool_scale[l]) @ w_branch_pool[l]
        y_attn = moba_attention(q, k, v, slopes) @ w_branch_attn[l]
        merged = gates[:, :, 0] * y_pool + gates[:, :, 1] * y_attn
        h = h + merged @ w_out[l]

        h = h + 0.5 * swiglu(rms_norm(h, ffn2_norm[l]), ffn2_w_gate[l], ffn2_w_up[l], ffn2_w_down[l])
    return rms_norm(h, final_norm)
```

```cpp
#include <hip/hip_runtime.h>
#include <stdint.h>
#include <stdio.h>

typedef unsigned short bf16_t;
typedef short bf16x8 __attribute__((ext_vector_type(8)));
typedef float f32x4 __attribute__((ext_vector_type(4)));

constexpr int T = 65536, DM = 1024, FF = 2816, SEQ = 2048;
constexpr size_t MB = 1024 * 1024;
constexpr size_t WS_CTR = 0;
constexpr size_t WS_XN = 1 * MB;
constexpr size_t WS_HM = WS_XN + (size_t)T * 1024 * 2;
constexpr size_t WS_GATES = WS_HM + (size_t)T * 2816 * 2;
constexpr size_t WS_KMEAN = WS_GATES + (size_t)T * 2048 * 2;
constexpr size_t WS_GU1 = WS_KMEAN + 1 * MB;
constexpr size_t WS_D1 = WS_GU1 + (size_t)5632 * 1024 * 2;
constexpr size_t WS_WIN = WS_D1 + (size_t)1024 * 2816 * 2;
constexpr size_t WS_POOL = WS_WIN + (size_t)4096 * 1024 * 2;
constexpr size_t WS_WBP = WS_POOL + (size_t)4 * 128 * 128 * 2;
constexpr size_t WS_WBA = WS_WBP + (size_t)1024 * 512 * 2;
constexpr size_t WS_WOUT = WS_WBA + (size_t)1024 * 512 * 2;
constexpr size_t WS_GU2 = WS_WOUT + (size_t)1024 * 1024 * 2;
constexpr size_t WS_D2 = WS_GU2 + (size_t)5632 * 1024 * 2;
constexpr size_t WS_END = WS_D2 + (size_t)1024 * 2816 * 2;

struct Params {
    const float* in[17];
    float* out;
    unsigned char* ws;
};

__device__ __forceinline__ bf16_t f2bf(float f) { unsigned u = __float_as_uint(f); u += 0x7fffu + ((u >> 16) & 1u); return (bf16_t)(u >> 16); }
__device__ __forceinline__ float bf2f(bf16_t b) { return __uint_as_float(((unsigned)b) << 16); }
__device__ __forceinline__ unsigned pack2(float a, float b) { return (unsigned)f2bf(a) | ((unsigned)f2bf(b) << 16); }

__device__ __forceinline__ void grid_bar(unsigned* ctr, unsigned& epoch) {
    __threadfence();
    __syncthreads();
    epoch += gridDim.x;
    if (threadIdx.x == 0) {
        __hip_atomic_fetch_add(ctr, 1u, __ATOMIC_RELEASE, __HIP_MEMORY_SCOPE_AGENT);
        while (__hip_atomic_load(ctr, __ATOMIC_ACQUIRE, __HIP_MEMORY_SCOPE_AGENT) < epoch) __builtin_amdgcn_s_sleep(4);
    }
    __syncthreads();
    __threadfence();
}

__device__ void xpose(const float* W0, const float* W1, int ldw, int K, int Nout, int mode, const float* cs, bf16_t* Bt, float* tile) {
    const int tk = K / 64, tn = Nout / 64;
    const int tx = threadIdx.x & 63, ty = threadIdx.x >> 6;
    for (int t = blockIdx.x; t < tk * tn; t += gridDim.x) {
        const int k0 = (t % tk) * 64, n0 = (t / tk) * 64;
        const int np = n0 + tx; const float* W = W0; int sc = np;
        if (mode == 1) { const int b16 = np >> 4; sc = (b16 >> 1) * 16 + (np & 15); W = (b16 & 1) ? W1 : W0; }
        const float s = cs ? cs[np] : 1.f;
        for (int r = ty; r < 64; r += 4) tile[r * 65 + tx] = W[(size_t)(k0 + r) * ldw + sc] * s;
        __syncthreads();
        for (int r = ty; r < 64; r += 4) Bt[(size_t)(n0 + r) * K + k0 + tx] = f2bf(tile[tx * 65 + r]);
        __syncthreads();
    }
}

__device__ void rms_rows(const float* X, const float* gain, bf16_t* outb, float* outf) {
    const int lane = threadIdx.x & 63, wv = threadIdx.x >> 6;
    for (int row = blockIdx.x * 4 + wv; row < T; row += gridDim.x * 4) {
        const float4* xp = (const float4*)(X + (size_t)row * 1024);
        float4 v[4]; float ss = 0.f;
#pragma unroll
        for (int i = 0; i < 4; ++i) { v[i] = xp[lane + 64 * i]; ss += v[i].x * v[i].x + v[i].y * v[i].y + v[i].z * v[i].z + v[i].w * v[i].w; }
#pragma unroll
        for (int o = 1; o < 64; o <<= 1) ss += __shfl_xor(ss, o);
        const float r = rsqrtf(ss * (1.0f / 1024.0f) + 1e-6f);
#pragma unroll
        for (int i = 0; i < 4; ++i) {
            const float4 g = ((const float4*)gain)[lane + 64 * i];
            const float a = v[i].x * r * g.x, b = v[i].y * r * g.y, c = v[i].z * r * g.z, d = v[i].w * r * g.w;
            if (outb) { uint2 w; w.x = pack2(a, b); w.y = pack2(c, d); *(uint2*)(outb + (size_t)row * 1024 + (lane + 64 * i) * 4) = w; }
            else { float4 o4; o4.x = a; o4.y = b; o4.z = c; o4.w = d; ((float4*)(outf + (size_t)row * 1024))[lane + 64 * i] = o4; }
        }
    }
}

struct GA {
    const bf16_t* A; int lda; const bf16_t* Bt; int K; int M; int N;
    float* outf; const float* resf; float scale;
    bf16_t* outb; int ldc; const bf16_t* gate; int goff; int add; bf16_t* outb2;
};

template <int MODE>
__device__ __forceinline__ void gemm_tile(const GA& g, int m0, int n0, bf16_t* sm) {
    const int tid = threadIdx.x, lane = tid & 63, wave = tid >> 6, wr = wave >> 1, wc = wave & 1, fr = lane & 15, fq = lane >> 4;
    f32x4 acc[4][4];
#pragma unroll
    for (int i = 0; i < 4; ++i)
#pragma unroll
        for (int j = 0; j < 4; ++j) acc[i][j] = (f32x4){0.f, 0.f, 0.f, 0.f};
    const int r0 = tid >> 2, kq = (tid & 3) * 8;
    const bf16_t* Ap = g.A + (size_t)(m0 + r0) * g.lda + kq;
    const bf16_t* Bp = g.Bt + (size_t)(n0 + r0) * g.K + kq;
    const size_t a64 = (size_t)64 * g.lda, b64 = (size_t)64 * g.K;
    bf16_t* As = sm; bf16_t* Bs = sm + 2 * 5120;
    uint4 ra0 = *(const uint4*)Ap, ra1 = *(const uint4*)(Ap + a64), rb0 = *(const uint4*)Bp, rb1 = *(const uint4*)(Bp + b64);
    *(uint4*)(As + r0 * 40 + kq) = ra0; *(uint4*)(As + (r0 + 64) * 40 + kq) = ra1;
    *(uint4*)(Bs + r0 * 40 + kq) = rb0; *(uint4*)(Bs + (r0 + 64) * 40 + kq) = rb1;
    __syncthreads();
    const int nk = g.K / 32;
    for (int kt = 0; kt < nk; ++kt) {
        const int buf = kt & 1;
        const bool more = kt + 1 < nk;
        if (more) { Ap += 32; Bp += 32; ra0 = *(const uint4*)Ap; ra1 = *(const uint4*)(Ap + a64); rb0 = *(const uint4*)Bp; rb1 = *(const uint4*)(Bp + b64); }
        bf16x8 af[4], bfr[4];
#pragma unroll
        for (int i = 0; i < 4; ++i) af[i] = *(const bf16x8*)(As + buf * 5120 + (wr * 64 + i * 16 + fr) * 40 + fq * 8);
#pragma unroll
        for (int j = 0; j < 4; ++j) bfr[j] = *(const bf16x8*)(Bs + buf * 5120 + (wc * 64 + j * 16 + fr) * 40 + fq * 8);
#pragma unroll
        for (int i = 0; i < 4; ++i)
#pragma unroll
            for (int j = 0; j < 4; ++j) acc[i][j] = __builtin_amdgcn_mfma_f32_16x16x32_bf16(bfr[j], af[i], acc[i][j], 0, 0, 0);
        if (more) {
            const int nb = (buf ^ 1) * 5120;
            *(uint4*)(As + nb + r0 * 40 + kq) = ra0; *(uint4*)(As + nb + (r0 + 64) * 40 + kq) = ra1;
            *(uint4*)(Bs + nb + r0 * 40 + kq) = rb0; *(uint4*)(Bs + nb + (r0 + 64) * 40 + kq) = rb1;
        }
        __syncthreads();
    }
#pragma unroll
    for (int i = 0; i < 4; ++i) {
        const size_t row = (size_t)(m0 + wr * 64 + i * 16 + fr);
#pragma unroll
        for (int j = 0; j < 4; ++j) {
            const int col = n0 + wc * 64 + j * 16 + 4 * fq;
            const f32x4 v = acc[i][j];
            if (MODE == 0) {
                if (j & 1) continue;
                const f32x4 u = acc[i][j | 1];
                const int hid = ((n0 + wc * 64 + j * 16) >> 5) * 16 + 4 * fq;
                float o[4];
#pragma unroll
                for (int e = 0; e < 4; ++e) o[e] = v[e] / (1.f + __expf(-v[e])) * u[e];
                uint2 w; w.x = pack2(o[0], o[1]); w.y = pack2(o[2], o[3]);
                *(uint2*)(g.outb + row * FF + hid) = w;
            } else if (MODE == 1) {
                const float4 rs = *(const float4*)(g.resf + row * 1024 + col);
                float4 o; o.x = rs.x + g.scale * v[0]; o.y = rs.y + g.scale * v[1]; o.z = rs.z + g.scale * v[2]; o.w = rs.w + g.scale * v[3];
                *(float4*)(g.outf + row * 1024 + col) = o;
            } else if (MODE == 2) {
                uint2 w;
                if (n0 < 2048) { w.x = pack2(v[0], v[1]); w.y = pack2(v[2], v[3]); *(uint2*)(g.outb + row * 2048 + col) = w; }
                else {
                    float o[4];
#pragma unroll
                    for (int e = 0; e < 4; ++e) o[e] = 1.f / (1.f + __expf(-v[e]));
                    w.x = pack2(o[0], o[1]); w.y = pack2(o[2], o[3]); *(uint2*)(g.outb2 + row * 2048 + (col - 2048)) = w;
                }
            } else if (MODE == 3) {
                const uint2 gw = *(const uint2*)(g.gate + row * 2048 + g.goff + col);
                float o[4];
                o[0] = bf2f((bf16_t)(gw.x & 0xffff)) * v[0]; o[1] = bf2f((bf16_t)(gw.x >> 16)) * v[1];
                o[2] = bf2f((bf16_t)(gw.y & 0xffff)) * v[2]; o[3] = bf2f((bf16_t)(gw.y >> 16)) * v[3];
                if (g.add) {
                    const uint2 pw = *(const uint2*)(g.outb + row * 1024 + col);
                    o[0] += bf2f((bf16_t)(pw.x & 0xffff)); o[1] += bf2f((bf16_t)(pw.x >> 16));
                    o[2] += bf2f((bf16_t)(pw.y & 0xffff)); o[3] += bf2f((bf16_t)(pw.y >> 16));
                }
                uint2 w; w.x = pack2(o[0], o[1]); w.y = pack2(o[2], o[3]);
                *(uint2*)(g.outb + row * 1024 + col) = w;
            } else {
                uint2 w; w.x = pack2(v[0], v[1]); w.y = pack2(v[2], v[3]);
                *(uint2*)(g.outb + row * g.ldc + col) = w;
            }
        }
    }
}

template <int MODE>
__device__ __forceinline__ void gemm_phase(const GA& g, bf16_t* sm) {
    const int nN = g.N / 128, nt = (g.M / 128) * nN;
    for (int t = blockIdx.x; t < nt; t += gridDim.x) gemm_tile<MODE>(g, (t / nN) * 128, (t % nN) * 128, sm);
}

__device__ void mixed_phase(const bf16_t* pqkv, bf16_t* mixed, float* kmean) {
    const size_t total = (size_t)T * 128;
    for (size_t e = (size_t)blockIdx.x * 256 + threadIdx.x; e < total; e += (size_t)gridDim.x * 256) {
        const int c4 = (int)(e & 127) * 4; const size_t t = e >> 7; const int s = (int)(t & (SEQ - 1));
        const int w = 2 << (c4 >> 7);
        const int cnt = (s + 1 < w) ? (s + 1) : w;
        float a0 = 0.f, a1 = 0.f, a2 = 0.f, a3 = 0.f; float p0 = 0.f, p1 = 0.f, p2 = 0.f, p3 = 0.f;
        for (int j = 0; j < cnt; ++j) {
            const uint2 pw = *(const uint2*)(pqkv + (t - j) * 2048 + c4);
            const float x0 = bf2f((bf16_t)(pw.x & 0xffff)), x1 = bf2f((bf16_t)(pw.x >> 16)), x2 = bf2f((bf16_t)(pw.y & 0xffff)), x3 = bf2f((bf16_t)(pw.y >> 16));
            if (j == 0) { p0 = x0; p1 = x1; p2 = x2; p3 = x3; }
            a0 += x0; a1 += x1; a2 += x2; a3 += x3;
        }
        const float ic = 1.f / (float)cnt;
        uint2 w2; w2.x = pack2(a0 * ic - p0, a1 * ic - p1); w2.y = pack2(a2 * ic - p2, a3 * ic - p3);
        *(uint2*)(mixed + t * 512 + c4) = w2;
    }
    const int lane = threadIdx.x & 63, wv = threadIdx.x >> 6;
    for (int u = blockIdx.x * 4 + wv; u < 32 * 8 * 8; u += gridDim.x * 4) {
        const int n = u & 7, h = (u >> 3) & 7, b = u >> 6;
        const bf16_t* kp = pqkv + ((size_t)b * SEQ + n * 256) * 2048 + 1024 + h * 64 + lane;
        float s = 0.f;
        for (int i = 0; i < 256; ++i) s += bf2f(kp[(size_t)i * 2048]);
        kmean[(size_t)u * 64 + lane] = s * (1.f / 256.f);
    }
}

__device__ __forceinline__ void attn_unit(const bf16_t* pqkv, const float* kmean, bf16_t* aout, int u, int lane) {
    const int qt = u & 127, bh = u >> 7, h = bh & 7, b = bh >> 3;
    const int fr = lane & 15, fq = lane >> 4;
    const int q0 = qt * 16, own = q0 >> 8, tq = q0 + fr;
    const size_t tokbase = (size_t)b * SEQ;
    const float NEG = -__builtin_inff();
    const bf16_t* qp = pqkv + (tokbase + tq) * 2048 + 512 + h * 64;
    bf16x8 qf[2];
    qf[0] = *(const bf16x8*)(qp + 8 * fq); qf[1] = *(const bf16x8*)(qp + 32 + 8 * fq);
    unsigned selmask;
    if (own <= 3) selmask = (1u << own) - 1u;
    else {
        float gt[8];
#pragma unroll
        for (int n = 0; n < 8; ++n) {
            float s = 0.f;
            if (n < own) {
                const float* km = kmean + ((size_t)bh * 8 + n) * 64 + 8 * fq;
#pragma unroll
                for (int c = 0; c < 2; ++c)
#pragma unroll
                    for (int i = 0; i < 8; ++i) s += bf2f((bf16_t)qf[c][i]) * km[32 * c + i];
            }
            s += __shfl_xor(s, 16); s += __shfl_xor(s, 32);
            gt[n] = (n < own) ? s : NEG;
        }
        selmask = 0u;
#pragma unroll
        for (int n = 0; n < 8; ++n) {
            int rank = 0;
#pragma unroll
            for (int m = 0; m < 8; ++m) if (m != n) rank += ((gt[m] > gt[n]) || (gt[m] == gt[n] && m < n)) ? 1 : 0;
            if (n < own && rank < 3) selmask |= 1u << n;
        }
    }
    const float slope = exp2f(-(float)(h + 1));
    float mrun = NEG, lsum = 0.f;
    f32x4 o[4];
#pragma unroll
    for (int d = 0; d < 4; ++d) o[d] = (f32x4){0.f, 0.f, 0.f, 0.f};
    const bf16_t* kbase_p = pqkv + tokbase * 2048 + 1024 + h * 64;
    const bf16_t* vbase_p = pqkv + tokbase * 2048 + 1536 + h * 64;
    for (int bi = 0; bi <= own; ++bi) {
        const bool is_own = (bi == 0);
        const int nblk = is_own ? own : (bi - 1);
        const bool rowsel = is_own ? true : (((selmask >> nblk) & 1u) != 0u);
        if (__ballot(rowsel) == 0ull) continue;
        const int kb0 = nblk * 256;
        const int nch = is_own ? ((q0 + 15 - kb0) / 32 + 1) : 8;
        for (int ch = 0; ch < nch; ++ch) {
            const int kb = kb0 + 32 * ch;
            f32x4 s0 = (f32x4){0.f, 0.f, 0.f, 0.f}, s1 = (f32x4){0.f, 0.f, 0.f, 0.f};
#pragma unroll
            for (int c = 0; c < 2; ++c) {
                const bf16x8 k0 = *(const bf16x8*)(kbase_p + (size_t)(kb + fr) * 2048 + 32 * c + 8 * fq);
                const bf16x8 k1 = *(const bf16x8*)(kbase_p + (size_t)(kb + 16 + fr) * 2048 + 32 * c + 8 * fq);
                s0 = __builtin_amdgcn_mfma_f32_16x16x32_bf16(k0, qf[c], s0, 0, 0, 0);
                s1 = __builtin_amdgcn_mfma_f32_16x16x32_bf16(k1, qf[c], s1, 0, 0, 0);
            }
            float p[8]; float mx = NEG;
#pragma unroll
            for (int i = 0; i < 4; ++i) {
                const int key0 = kb + 4 * fq + i, key1 = key0 + 16;
                const float v0 = s0[i] * 0.125f - slope * (float)(tq - key0);
                const float v1 = s1[i] * 0.125f - slope * (float)(tq - key1);
                p[i] = (rowsel && key0 <= tq) ? v0 : NEG;
                p[4 + i] = (rowsel && key1 <= tq) ? v1 : NEG;
                mx = fmaxf(mx, fmaxf(p[i], p[4 + i]));
            }
            mx = fmaxf(mx, __shfl_xor(mx, 16)); mx = fmaxf(mx, __shfl_xor(mx, 32));
            const float mnew = fmaxf(mrun, mx);
            const float alpha = (mrun == NEG) ? 0.f : __expf(mrun - mnew);
            float ps = 0.f;
#pragma unroll
            for (int i = 0; i < 8; ++i) { p[i] = (p[i] == NEG) ? 0.f : __expf(p[i] - mnew); ps += p[i]; }
            lsum = lsum * alpha + ps; mrun = mnew;
            bf16x8 pb;
#pragma unroll
            for (int i = 0; i < 8; ++i) pb[i] = (short)f2bf(p[i]);
#pragma unroll
            for (int d = 0; d < 4; ++d) {
                o[d] = o[d] * alpha;
                bf16x8 vf;
#pragma unroll
                for (int i = 0; i < 8; ++i) {
                    const int key = kb + ((i < 4) ? (4 * fq + i) : (16 + 4 * fq + i - 4));
                    vf[i] = (short)vbase_p[(size_t)key * 2048 + 16 * d + fr];
                }
                o[d] = __builtin_amdgcn_mfma_f32_16x16x32_bf16(vf, pb, o[d], 0, 0, 0);
            }
        }
    }
    lsum += __shfl_xor(lsum, 16); lsum += __shfl_xor(lsum, 32);
    const float il = 1.f / lsum;
#pragma unroll
    for (int d = 0; d < 4; ++d) {
        uint2 w; w.x = pack2(o[d][0] * il, o[d][1] * il); w.y = pack2(o[d][2] * il, o[d][3] * il);
        *(uint2*)(aout + (tokbase + tq) * 512 + h * 64 + 16 * d + 4 * fq) = w;
    }
}

__global__ __launch_bounds__(256) void fwd(Params p) {
    __shared__ __attribute__((aligned(16))) unsigned char smem[40960];
    bf16_t* sm = (bf16_t*)smem;
    unsigned char* ws = p.ws;
    unsigned* ctr = (unsigned*)(ws + WS_CTR);
    unsigned epoch = 0;
    bf16_t* XN = (bf16_t*)(ws + WS_XN);
    bf16_t* HM = (bf16_t*)(ws + WS_HM);
    bf16_t* PQKV = HM;
    bf16_t* MIXED = (bf16_t*)(ws + WS_HM + (size_t)T * 2048 * 2);
    bf16_t* MERGED = HM;
    bf16_t* YMIX = XN;
    bf16_t* AOUT = (bf16_t*)(ws + WS_XN + (size_t)T * 512 * 2);
    bf16_t* GATES = (bf16_t*)(ws + WS_GATES);
    float* KMEAN = (float*)(ws + WS_KMEAN);
    bf16_t* GU1 = (bf16_t*)(ws + WS_GU1); bf16_t* D1 = (bf16_t*)(ws + WS_D1); bf16_t* WIN = (bf16_t*)(ws + WS_WIN);
    bf16_t* POOLT = (bf16_t*)(ws + WS_POOL); bf16_t* WBP = (bf16_t*)(ws + WS_WBP); bf16_t* WBA = (bf16_t*)(ws + WS_WBA);
    bf16_t* WOUT = (bf16_t*)(ws + WS_WOUT); bf16_t* GU2 = (bf16_t*)(ws + WS_GU2); bf16_t* D2 = (bf16_t*)(ws + WS_D2);
    const float* x = p.in[0];
    float* hbuf = p.out;

    {
        float* tile = (float*)smem;
        xpose(p.in[2], p.in[3], FF, 1024, 5632, 1, nullptr, GU1, tile);
        xpose(p.in[4], nullptr, 1024, FF, 1024, 0, nullptr, D1, tile);
        xpose(p.in[6], nullptr, 4096, 1024, 4096, 0, nullptr, WIN, tile);
        for (int gi = 0; gi < 4; ++gi) xpose(p.in[7] + gi * 16384, nullptr, 128, 128, 128, 0, p.in[8] + gi * 128, POOLT + gi * 16384, tile);
        xpose(p.in[9], nullptr, 1024, 512, 1024, 0, nullptr, WBP, tile);
        xpose(p.in[10], nullptr, 1024, 512, 1024, 0, nullptr, WBA, tile);
        xpose(p.in[11], nullptr, 1024, 1024, 1024, 0, nullptr, WOUT, tile);
        xpose(p.in[13], p.in[14], FF, 1024, 5632, 1, nullptr, GU2, tile);
        xpose(p.in[15], nullptr, 1024, FF, 1024, 0, nullptr, D2, tile);
        rms_rows(x, p.in[1], XN, nullptr);
    }
    grid_bar(ctr, epoch);
    { GA g{}; g.A = XN; g.lda = 1024; g.Bt = GU1; g.K = 1024; g.M = T; g.N = 5632; g.outb = HM; gemm_phase<0>(g, sm); }
    grid_bar(ctr, epoch);
    { GA g{}; g.A = HM; g.lda = FF; g.Bt = D1; g.K = FF; g.M = T; g.N = 1024; g.outf = hbuf; g.resf = x; g.scale = 0.5f; gemm_phase<1>(g, sm); }
    grid_bar(ctr, epoch);
    rms_rows(hbuf, p.in[5], XN, nullptr);
    grid_bar(ctr, epoch);
    { GA g{}; g.A = XN; g.lda = 1024; g.Bt = WIN; g.K = 1024; g.M = T; g.N = 4096; g.outb = PQKV; g.outb2 = GATES; gemm_phase<2>(g, sm); }
    grid_bar(ctr, epoch);
    mixed_phase(PQKV, MIXED, KMEAN);
    grid_bar(ctr, epoch);
    {
        for (int t = blockIdx.x; t < 2048; t += gridDim.x) {
            const int gi = t & 3, mt = t >> 2;
            GA g{}; g.A = MIXED + gi * 128; g.lda = 512; g.Bt = POOLT + gi * 16384; g.K = 128; g.M = T; g.N = 128; g.outb = YMIX + gi * 128; g.ldc = 512;
            gemm_tile<4>(g, mt * 128, 0, sm);
        }
        const int lane = threadIdx.x & 63, wv = threadIdx.x >> 6;
        for (int u = blockIdx.x * 4 + wv; u < 32 * 8 * 128; u += gridDim.x * 4) attn_unit(PQKV, KMEAN, AOUT, u, lane);
    }
    grid_bar(ctr, epoch);
    { GA g{}; g.A = YMIX; g.lda = 512; g.Bt = WBP; g.K = 512; g.M = T; g.N = 1024; g.outb = MERGED; g.gate = GATES; g.goff = 0; g.add = 0; gemm_phase<3>(g, sm); }
    grid_bar(ctr, epoch);
    { GA g{}; g.A = AOUT; g.lda = 512; g.Bt = WBA; g.K = 512; g.M = T; g.N = 1024; g.outb = MERGED; g.gate = GATES; g.goff = 1024; g.add = 1; gemm_phase<3>(g, sm); }
    grid_bar(ctr, epoch);
    { GA g{}; g.A = MERGED; g.lda = 1024; g.Bt = WOUT; g.K = 1024; g.M = T; g.N = 1024; g.outf = hbuf; g.resf = hbuf; g.scale = 1.0f; gemm_phase<1>(g, sm); }
    grid_bar(ctr, epoch);
    rms_rows(hbuf, p.in[12], XN, nullptr);
    grid_bar(ctr, epoch);
    { GA g{}; g.A = XN; g.lda = 1024; g.Bt = GU2; g.K = 1024; g.M = T; g.N = 5632; g.outb = HM; gemm_phase<0>(g, sm); }
    grid_bar(ctr, epoch);
    { GA g{}; g.A = HM; g.lda = FF; g.Bt = D2; g.K = FF; g.M = T; g.N = 1024; g.outf = hbuf; g.resf = hbuf; g.scale = 0.5f; gemm_phase<1>(g, sm); }
    grid_bar(ctr, epoch);
    rms_rows(hbuf, p.in[16], nullptr, hbuf);
}

extern "C" void kernel_launch(void* const* d_in, const int* in_sizes, int n_in, void* d_out, int out_size, void* d_ws, size_t ws_size, hipStream_t stream) {
    static int grid = 0;
    if (grid == 0) {
        if (n_in != 17 || ws_size < WS_END) { fprintf(stderr, "kernel_launch: bad args n_in=%d ws=%zu need %zu\n", n_in, ws_size, (size_t)WS_END); grid = -1; return; }
        int dev = 0, cus = 0, per_cu = 0;
        hipGetDevice(&dev);
        hipDeviceGetAttribute(&cus, hipDeviceAttributeMultiprocessorCount, dev);
        if (hipOccupancyMaxActiveBlocksPerMultiprocessor(&per_cu, (const void*)fwd, 256, 0) != hipSuccess || per_cu < 1) per_cu = 1;
        if (per_cu > 2) per_cu = 2;
        grid = cus * per_cu;
    }
    if (grid < 0) return;
    hipMemsetAsync((char*)d_ws + WS_CTR, 0, 256, stream);
    Params p{};
    for (int i = 0; i < 17; ++i) p.in[i] = (const float*)d_in[i];
    p.out = (float*)d_out; p.ws = (unsigned char*)d_ws;
    hipLaunchKernelGGL(fwd, dim3(grid), dim3(256), 0, stream, p);
}
```

```cpp
#include <hip/hip_runtime.h>
#include <stdint.h>
#include <stdio.h>

typedef unsigned short bf16_t;
typedef short bf16x8 __attribute__((ext_vector_type(8)));
typedef float f32x4 __attribute__((ext_vector_type(4)));

constexpr int T = 65536, DM = 1024, FF = 2816, SEQ = 2048;
constexpr size_t MB = 1024 * 1024;
constexpr int LDS_BYTES = 65536;
constexpr size_t WS_CTR = 0;
constexpr size_t WS_XN = 1 * MB;
constexpr size_t WS_HM = WS_XN + (size_t)T * 1024 * 2;
constexpr size_t WS_GATES = WS_HM + (size_t)T * 2816 * 2;
constexpr size_t WS_KMEAN = WS_GATES + (size_t)T * 2048 * 2;
constexpr size_t WS_GU1 = WS_KMEAN + 1 * MB;
constexpr size_t WS_D1 = WS_GU1 + (size_t)5632 * 1024 * 2;
constexpr size_t WS_WIN = WS_D1 + (size_t)1024 * 2816 * 2;
constexpr size_t WS_POOL = WS_WIN + (size_t)4096 * 1024 * 2;
constexpr size_t WS_WBP = WS_POOL + (size_t)4 * 128 * 128 * 2;
constexpr size_t WS_WBA = WS_WBP + (size_t)1024 * 512 * 2;
constexpr size_t WS_WOUT = WS_WBA + (size_t)1024 * 512 * 2;
constexpr size_t WS_GU2 = WS_WOUT + (size_t)1024 * 1024 * 2;
constexpr size_t WS_D2 = WS_GU2 + (size_t)5632 * 1024 * 2;
constexpr size_t WS_END = WS_D2 + (size_t)1024 * 2816 * 2;

struct Params {
    const float* in[17];
    float* out;
    unsigned char* ws;
};

__device__ __forceinline__ bf16_t f2bf(float f) { unsigned u = __float_as_uint(f); u += 0x7fffu + ((u >> 16) & 1u); return (bf16_t)(u >> 16); }
__device__ __forceinline__ float bf2f(bf16_t b) { return __uint_as_float(((unsigned)b) << 16); }
__device__ __forceinline__ unsigned pack2(float a, float b) { return (unsigned)f2bf(a) | ((unsigned)f2bf(b) << 16); }

__device__ __forceinline__ void grid_bar(unsigned* ctr, unsigned& epoch) {
    asm volatile("s_waitcnt vmcnt(0)" ::: "memory");
    __syncthreads();
    epoch += gridDim.x;
    if (threadIdx.x == 0) {
        __builtin_amdgcn_fence(__ATOMIC_RELEASE, "agent");
        asm volatile("s_waitcnt vmcnt(0)" ::: "memory");
        __hip_atomic_fetch_add(ctr, 1u, __ATOMIC_RELAXED, __HIP_MEMORY_SCOPE_AGENT);
        while (__hip_atomic_load(ctr, __ATOMIC_RELAXED, __HIP_MEMORY_SCOPE_AGENT) < epoch) __builtin_amdgcn_s_sleep(2);
        __builtin_amdgcn_fence(__ATOMIC_ACQUIRE, "agent");
        asm volatile("s_waitcnt vmcnt(0)" ::: "memory");
    }
    __syncthreads();
}

__device__ void xpose(const float* W0, const float* W1, int ldw, int K, int Nout, int mode, const float* cs, bf16_t* Bt, float* tile) {
    const int tk = K / 64, tn = Nout / 64;
    const int tx = threadIdx.x & 63, ty = threadIdx.x >> 6;
    for (int t = blockIdx.x; t < tk * tn; t += gridDim.x) {
        const int k0 = (t % tk) * 64, n0 = (t / tk) * 64;
        const int np = n0 + tx; const float* W = W0; int sc = np;
        if (mode == 1) { const int b16 = np >> 4; sc = (b16 >> 1) * 16 + (np & 15); W = (b16 & 1) ? W1 : W0; }
        const float s = cs ? cs[np] : 1.f;
        for (int r = ty; r < 64; r += 4) tile[r * 65 + tx] = W[(size_t)(k0 + r) * ldw + sc] * s;
        __syncthreads();
        for (int r = ty; r < 64; r += 4) Bt[(size_t)(n0 + r) * K + k0 + tx] = f2bf(tile[tx * 65 + r]);
        __syncthreads();
    }
}

__device__ void rms_rows(const float* X, const float* gain, bf16_t* outb, float* outf) {
    const int lane = threadIdx.x & 63, wv = threadIdx.x >> 6;
    for (int row = blockIdx.x * 4 + wv; row < T; row += gridDim.x * 4) {
        const float4* xp = (const float4*)(X + (size_t)row * 1024);
        float4 v[4]; float ss = 0.f;
#pragma unroll
        for (int i = 0; i < 4; ++i) { v[i] = xp[lane + 64 * i]; ss += v[i].x * v[i].x + v[i].y * v[i].y + v[i].z * v[i].z + v[i].w * v[i].w; }
#pragma unroll
        for (int o = 1; o < 64; o <<= 1) ss += __shfl_xor(ss, o);
        const float r = rsqrtf(ss * (1.0f / 1024.0f) + 1e-6f);
#pragma unroll
        for (int i = 0; i < 4; ++i) {
            const float4 g = ((const float4*)gain)[lane + 64 * i];
            const float a = v[i].x * r * g.x, b = v[i].y * r * g.y, c = v[i].z * r * g.z, d = v[i].w * r * g.w;
            if (outb) { uint2 w; w.x = pack2(a, b); w.y = pack2(c, d); *(uint2*)(outb + (size_t)row * 1024 + (lane + 64 * i) * 4) = w; }
            else { float4 o4; o4.x = a; o4.y = b; o4.z = c; o4.w = d; ((float4*)(outf + (size_t)row * 1024))[lane + 64 * i] = o4; }
        }
    }
}

struct GA {
    const bf16_t* A; int lda; const bf16_t* Bt; int K; int M; int N;
    float* outf; const float* resf; float scale;
    bf16_t* outb; int ldc; const bf16_t* gate; int goff; int add; bf16_t* outb2;
};

template <int MODE>
__device__ __forceinline__ void gemm_tile(const GA& g, int m0, int n0, bf16_t* sm) {
    const int tid = threadIdx.x, lane = tid & 63, wave = tid >> 6, wr = wave >> 1, wc = wave & 1, fr = lane & 15, fq = lane >> 4;
    f32x4 acc[4][4];
#pragma unroll
    for (int i = 0; i < 4; ++i)
#pragma unroll
        for (int j = 0; j < 4; ++j) acc[i][j] = (f32x4){0.f, 0.f, 0.f, 0.f};
    typedef __attribute__((address_space(3))) unsigned LDSU;
    __attribute__((address_space(3))) unsigned char* lds = (__attribute__((address_space(3))) unsigned char*)sm;
    const int lr = lane >> 3, sch = (lane & 7) ^ lr;
    const bf16_t* Ap = g.A + (size_t)(m0 + wave * 32 + lr) * g.lda + sch * 8;
    const bf16_t* Bp = g.Bt + (size_t)(n0 + wave * 32 + lr) * g.K + sch * 8;
    const size_t a8 = (size_t)8 * g.lda, b8 = (size_t)8 * g.K;
    const int wbase = __builtin_amdgcn_readfirstlane(wave * 4096);
#define STAGE(bufi) do { _Pragma("unroll") for (int i_ = 0; i_ < 4; ++i_) { \
        __builtin_amdgcn_global_load_lds((const unsigned*)(Ap + i_ * a8), (LDSU*)(lds + (bufi) * 32768 + wbase + i_ * 1024), 16, 0, 0); \
        __builtin_amdgcn_global_load_lds((const unsigned*)(Bp + i_ * b8), (LDSU*)(lds + (bufi) * 32768 + 16384 + wbase + i_ * 1024), 16, 0, 0); } } while (0)
    STAGE(0);
    asm volatile("s_waitcnt vmcnt(0)" ::: "memory");
    __syncthreads();
    const unsigned char* smb = (const unsigned char*)sm;
    const int nk = g.K / 64;
    for (int kt = 0; kt < nk; ++kt) {
        const int buf = kt & 1;
        if (kt + 1 < nk) { Ap += 64; Bp += 64; if (buf) STAGE(0); else STAGE(1); }
#pragma unroll
        for (int kk = 0; kk < 2; ++kk) {
            bf16x8 af[4], bfr[4];
            const int sl = ((kk * 4 + fq) ^ (fr & 7)) * 16;
#pragma unroll
            for (int i = 0; i < 4; ++i) af[i] = *(const bf16x8*)(smb + buf * 32768 + (wr * 64 + i * 16 + fr) * 128 + sl);
#pragma unroll
            for (int j = 0; j < 4; ++j) bfr[j] = *(const bf16x8*)(smb + buf * 32768 + 16384 + (wc * 64 + j * 16 + fr) * 128 + sl);
#pragma unroll
            for (int i = 0; i < 4; ++i)
#pragma unroll
                for (int j = 0; j < 4; ++j) acc[i][j] = __builtin_amdgcn_mfma_f32_16x16x32_bf16(bfr[j], af[i], acc[i][j], 0, 0, 0);
        }
        asm volatile("s_waitcnt vmcnt(0)" ::: "memory");
        __syncthreads();
    }
#undef STAGE
#pragma unroll
    for (int i = 0; i < 4; ++i) {
        const size_t row = (size_t)(m0 + wr * 64 + i * 16 + fr);
#pragma unroll
        for (int j = 0; j < 4; ++j) {
            const int col = n0 + wc * 64 + j * 16 + 4 * fq;
            const f32x4 v = acc[i][j];
            if (MODE == 0) {
                if (j & 1) continue;
                const f32x4 u = acc[i][j | 1];
                const int hid = ((n0 + wc * 64 + j * 16) >> 5) * 16 + 4 * fq;
                float o[4];
#pragma unroll
                for (int e = 0; e < 4; ++e) o[e] = v[e] / (1.f + __expf(-v[e])) * u[e];
                uint2 w; w.x = pack2(o[0], o[1]); w.y = pack2(o[2], o[3]);
                *(uint2*)(g.outb + row * FF + hid) = w;
            } else if (MODE == 1) {
                const float4 rs = *(const float4*)(g.resf + row * 1024 + col);
                float4 o; o.x = rs.x + g.scale * v[0]; o.y = rs.y + g.scale * v[1]; o.z = rs.z + g.scale * v[2]; o.w = rs.w + g.scale * v[3];
                *(float4*)(g.outf + row * 1024 + col) = o;
            } else if (MODE == 2) {
                uint2 w;
                if (n0 < 2048) { w.x = pack2(v[0], v[1]); w.y = pack2(v[2], v[3]); *(uint2*)(g.outb + row * 2048 + col) = w; }
                else {
                    float o[4];
#pragma unroll
                    for (int e = 0; e < 4; ++e) o[e] = 1.f / (1.f + __expf(-v[e]));
                    w.x = pack2(o[0], o[1]); w.y = pack2(o[2], o[3]); *(uint2*)(g.outb2 + row * 2048 + (col - 2048)) = w;
                }
            } else if (MODE == 3) {
                const uint2 gw = *(const uint2*)(g.gate + row * 2048 + g.goff + col);
                float o[4];
                o[0] = bf2f((bf16_t)(gw.x & 0xffff)) * v[0]; o[1] = bf2f((bf16_t)(gw.x >> 16)) * v[1];
                o[2] = bf2f((bf16_t)(gw.y & 0xffff)) * v[2]; o[3] = bf2f((bf16_t)(gw.y >> 16)) * v[3];
                if (g.add) {
                    const uint2 pw = *(const uint2*)(g.outb + row * 1024 + col);
                    o[0] += bf2f((bf16_t)(pw.x & 0xffff)); o[1] += bf2f((bf16_t)(pw.x >> 16));
                    o[2] += bf2f((bf16_t)(pw.y & 0xffff)); o[3] += bf2f((bf16_t)(pw.y >> 16));
                }
                uint2 w; w.x = pack2(o[0], o[1]); w.y = pack2(o[2], o[3]);
                *(uint2*)(g.outb + row * 1024 + col) = w;
            } else {
                uint2 w; w.x = pack2(v[0], v[1]); w.y = pack2(v[2], v[3]);
                *(uint2*)(g.outb + row * g.ldc + col) = w;
            }
        }
    }
}

template <int MODE>
__device__ __forceinline__ void gemm_phase(const GA& g, bf16_t* sm) {
    const int nN = g.N / 128, nM = g.M / 128;
    const int GN = (nN % 8 == 0) ? 8 : 4, GM = 64 / GN, nGN = nN / GN, ngroups = (nM / GM) * nGN;
    const int xcd = blockIdx.x & 7, local = blockIdx.x >> 3, per = gridDim.x >> 3;
    for (int L = local;; L += per) {
        const int gidx = (L >> 6) * 8 + xcd; if (gidx >= ngroups) break;
        const int w = L & 63;
        const int mt = (gidx / nGN) * GM + (w % GM), nt = (gidx % nGN) * GN + (w / GM);
        gemm_tile<MODE>(g, mt * 128, nt * 128, sm);
    }
}

__device__ void mixed_phase(const bf16_t* pqkv, bf16_t* mixed, float* kmean) {
    const size_t total = (size_t)T * 128;
    for (size_t e = (size_t)blockIdx.x * 256 + threadIdx.x; e < total; e += (size_t)gridDim.x * 256) {
        const int c4 = (int)(e & 127) * 4; const size_t t = e >> 7; const int s = (int)(t & (SEQ - 1));
        const int w = 2 << (c4 >> 7);
        const int cnt = (s + 1 < w) ? (s + 1) : w;
        float a0 = 0.f, a1 = 0.f, a2 = 0.f, a3 = 0.f; float p0 = 0.f, p1 = 0.f, p2 = 0.f, p3 = 0.f;
        for (int j = 0; j < cnt; ++j) {
            const uint2 pw = *(const uint2*)(pqkv + (t - j) * 2048 + c4);
            const float x0 = bf2f((bf16_t)(pw.x & 0xffff)), x1 = bf2f((bf16_t)(pw.x >> 16)), x2 = bf2f((bf16_t)(pw.y & 0xffff)), x3 = bf2f((bf16_t)(pw.y >> 16));
            if (j == 0) { p0 = x0; p1 = x1; p2 = x2; p3 = x3; }
            a0 += x0; a1 += x1; a2 += x2; a3 += x3;
        }
        const float ic = 1.f / (float)cnt;
        uint2 w2; w2.x = pack2(a0 * ic - p0, a1 * ic - p1); w2.y = pack2(a2 * ic - p2, a3 * ic - p3);
        *(uint2*)(mixed + t * 512 + c4) = w2;
    }
    const int lane = threadIdx.x & 63, wv = threadIdx.x >> 6;
    for (int u = blockIdx.x * 4 + wv; u < 32 * 8 * 8; u += gridDim.x * 4) {
        const int n = u & 7, h = (u >> 3) & 7, b = u >> 6;
        const bf16_t* kp = pqkv + ((size_t)b * SEQ + n * 256) * 2048 + 1024 + h * 64 + lane;
        float s = 0.f;
        for (int i = 0; i < 256; ++i) s += bf2f(kp[(size_t)i * 2048]);
        kmean[(size_t)u * 64 + lane] = s * (1.f / 256.f);
    }
}

__device__ __forceinline__ void attn_unit(const bf16_t* pqkv, const float* kmean, bf16_t* aout, int u, int lane) {
    const int qt = u & 127, bh = u >> 7, h = bh & 7, b = bh >> 3;
    const int fr = lane & 15, fq = lane >> 4;
    const int q0 = qt * 16, own = q0 >> 8, tq = q0 + fr;
    const size_t tokbase = (size_t)b * SEQ;
    const float NEG = -__builtin_inff();
    const bf16_t* qp = pqkv + (tokbase + tq) * 2048 + 512 + h * 64;
    bf16x8 qf[2];
    qf[0] = *(const bf16x8*)(qp + 8 * fq); qf[1] = *(const bf16x8*)(qp + 32 + 8 * fq);
    unsigned selmask;
    if (own <= 3) selmask = (1u << own) - 1u;
    else {
        float gt[8];
#pragma unroll
        for (int n = 0; n < 8; ++n) {
            float s = 0.f;
            if (n < own) {
                const float* km = kmean + ((size_t)bh * 8 + n) * 64 + 8 * fq;
#pragma unroll
                for (int c = 0; c < 2; ++c)
#pragma unroll
                    for (int i = 0; i < 8; ++i) s += bf2f((bf16_t)qf[c][i]) * km[32 * c + i];
            }
            s += __shfl_xor(s, 16); s += __shfl_xor(s, 32);
            gt[n] = (n < own) ? s : NEG;
        }
        selmask = 0u;
#pragma unroll
        for (int n = 0; n < 8; ++n) {
            int rank = 0;
#pragma unroll
            for (int m = 0; m < 8; ++m) if (m != n) rank += ((gt[m] > gt[n]) || (gt[m] == gt[n] && m < n)) ? 1 : 0;
            if (n < own && rank < 3) selmask |= 1u << n;
        }
    }
    const float slope = exp2f(-(float)(h + 1));
    float mrun = NEG, lsum = 0.f;
    f32x4 o[4];
#pragma unroll
    for (int d = 0; d < 4; ++d) o[d] = (f32x4){0.f, 0.f, 0.f, 0.f};
    const bf16_t* kbase_p = pqkv + tokbase * 2048 + 1024 + h * 64;
    const bf16_t* vbase_p = pqkv + tokbase * 2048 + 1536 + h * 64;
    for (int bi = 0; bi <= own; ++bi) {
        const bool is_own = (bi == 0);
        const int nblk = is_own ? own : (bi - 1);
        const bool rowsel = is_own ? true : (((selmask >> nblk) & 1u) != 0u);
        if (__ballot(rowsel) == 0ull) continue;
        const int kb0 = nblk * 256;
        const int nch = is_own ? ((q0 + 15 - kb0) / 32 + 1) : 8;
        for (int ch = 0; ch < nch; ++ch) {
            const int kb = kb0 + 32 * ch;
            f32x4 s0 = (f32x4){0.f, 0.f, 0.f, 0.f}, s1 = (f32x4){0.f, 0.f, 0.f, 0.f};
#pragma unroll
            for (int c = 0; c < 2; ++c) {
                const bf16x8 k0 = *(const bf16x8*)(kbase_p + (size_t)(kb + fr) * 2048 + 32 * c + 8 * fq);
                const bf16x8 k1 = *(const bf16x8*)(kbase_p + (size_t)(kb + 16 + fr) * 2048 + 32 * c + 8 * fq);
                s0 = __builtin_amdgcn_mfma_f32_16x16x32_bf16(k0, qf[c], s0, 0, 0, 0);
                s1 = __builtin_amdgcn_mfma_f32_16x16x32_bf16(k1, qf[c], s1, 0, 0, 0);
            }
            float p[8]; float mx = NEG;
#pragma unroll
            for (int i = 0; i < 4; ++i) {
                const int key0 = kb + 4 * fq + i, key1 = key0 + 16;
                const float v0 = s0[i] * 0.125f - slope * (float)(tq - key0);
                const float v1 = s1[i] * 0.125f - slope * (float)(tq - key1);
                p[i] = (rowsel && key0 <= tq) ? v0 : NEG;
                p[4 + i] = (rowsel && key1 <= tq) ? v1 : NEG;
                mx = fmaxf(mx, fmaxf(p[i], p[4 + i]));
            }
            mx = fmaxf(mx, __shfl_xor(mx, 16)); mx = fmaxf(mx, __shfl_xor(mx, 32));
            const float mnew = fmaxf(mrun, mx);
            const float alpha = (mrun == NEG) ? 0.f : __expf(mrun - mnew);
            float ps = 0.f;
#pragma unroll
            for (int i = 0; i < 8; ++i) { p[i] = (p[i] == NEG) ? 0.f : __expf(p[i] - mnew); ps += p[i]; }
            lsum = lsum * alpha + ps; mrun = mnew;
            bf16x8 pb;
#pragma unroll
            for (int i = 0; i < 8; ++i) pb[i] = (short)f2bf(p[i]);
#pragma unroll
            for (int d = 0; d < 4; ++d) {
                o[d] = o[d] * alpha;
                bf16x8 vf;
#pragma unroll
                for (int i = 0; i < 8; ++i) {
                    const int key = kb + ((i < 4) ? (4 * fq + i) : (16 + 4 * fq + i - 4));
                    vf[i] = (short)vbase_p[(size_t)key * 2048 + 16 * d + fr];
                }
                o[d] = __builtin_amdgcn_mfma_f32_16x16x32_bf16(vf, pb, o[d], 0, 0, 0);
            }
        }
    }
    lsum += __shfl_xor(lsum, 16); lsum += __shfl_xor(lsum, 32);
    const float il = 1.f / lsum;
#pragma unroll
    for (int d = 0; d < 4; ++d) {
        uint2 w; w.x = pack2(o[d][0] * il, o[d][1] * il); w.y = pack2(o[d][2] * il, o[d][3] * il);
        *(uint2*)(aout + (tokbase + tq) * 512 + h * 64 + 16 * d + 4 * fq) = w;
    }
}

__global__ __launch_bounds__(256) __attribute__((amdgpu_waves_per_eu(2, 2))) void fwd(Params p) {
    extern __shared__ __attribute__((aligned(16))) unsigned char smem[];
    bf16_t* sm = (bf16_t*)smem;
    unsigned char* ws = p.ws;
    unsigned* ctr = (unsigned*)(ws + WS_CTR);
    unsigned epoch = 0;
    bf16_t* XN = (bf16_t*)(ws + WS_XN);
    bf16_t* HM = (bf16_t*)(ws + WS_HM);
    bf16_t* PQKV = HM;
    bf16_t* MIXED = (bf16_t*)(ws + WS_HM + (size_t)T * 2048 * 2);
    bf16_t* MERGED = HM;
    bf16_t* YMIX = XN;
    bf16_t* AOUT = (bf16_t*)(ws + WS_XN + (size_t)T * 512 * 2);
    bf16_t* GATES = (bf16_t*)(ws + WS_GATES);
    float* KMEAN = (float*)(ws + WS_KMEAN);
    bf16_t* GU1 = (bf16_t*)(ws + WS_GU1); bf16_t* D1 = (bf16_t*)(ws + WS_D1); bf16_t* WIN = (bf16_t*)(ws + WS_WIN);
    bf16_t* POOLT = (bf16_t*)(ws + WS_POOL); bf16_t* WBP = (bf16_t*)(ws + WS_WBP); bf16_t* WBA = (bf16_t*)(ws + WS_WBA);
    bf16_t* WOUT = (bf16_t*)(ws + WS_WOUT); bf16_t* GU2 = (bf16_t*)(ws + WS_GU2); bf16_t* D2 = (bf16_t*)(ws + WS_D2);
    const float* x = p.in[0];
    float* hbuf = p.out;

    {
        float* tile = (float*)smem;
        xpose(p.in[2], p.in[3], FF, 1024, 5632, 1, nullptr, GU1, tile);
        xpose(p.in[4], nullptr, 1024, FF, 1024, 0, nullptr, D1, tile);
        xpose(p.in[6], nullptr, 4096, 1024, 4096, 0, nullptr, WIN, tile);
        for (int gi = 0; gi < 4; ++gi) xpose(p.in[7] + gi * 16384, nullptr, 128, 128, 128, 0, p.in[8] + gi * 128, POOLT + gi * 16384, tile);
        xpose(p.in[9], nullptr, 1024, 512, 1024, 0, nullptr, WBP, tile);
        xpose(p.in[10], nullptr, 1024, 512, 1024, 0, nullptr, WBA, tile);
        xpose(p.in[11], nullptr, 1024, 1024, 1024, 0, nullptr, WOUT, tile);
        xpose(p.in[13], p.in[14], FF, 1024, 5632, 1, nullptr, GU2, tile);
        xpose(p.in[15], nullptr, 1024, FF, 1024, 0, nullptr, D2, tile);
        rms_rows(x, p.in[1], XN, nullptr);
    }
    grid_bar(ctr, epoch);
    { GA g{}; g.A = XN; g.lda = 1024; g.Bt = GU1; g.K = 1024; g.M = T; g.N = 5632; g.outb = HM; gemm_phase<0>(g, sm); }
    grid_bar(ctr, epoch);
    { GA g{}; g.A = HM; g.lda = FF; g.Bt = D1; g.K = FF; g.M = T; g.N = 1024; g.outf = hbuf; g.resf = x; g.scale = 0.5f; gemm_phase<1>(g, sm); }
    grid_bar(ctr, epoch);
    rms_rows(hbuf, p.in[5], XN, nullptr);
    grid_bar(ctr, epoch);
    { GA g{}; g.A = XN; g.lda = 1024; g.Bt = WIN; g.K = 1024; g.M = T; g.N = 4096; g.outb = PQKV; g.outb2 = GATES; gemm_phase<2>(g, sm); }
    grid_bar(ctr, epoch);
    mixed_phase(PQKV, MIXED, KMEAN);
    grid_bar(ctr, epoch);
    {
        for (int t = blockIdx.x; t < 2048; t += gridDim.x) {
            const int gi = t & 3, mt = t >> 2;
            GA g{}; g.A = MIXED + gi * 128; g.lda = 512; g.Bt = POOLT + gi * 16384; g.K = 128; g.M = T; g.N = 128; g.outb = YMIX + gi * 128; g.ldc = 512;
            gemm_tile<4>(g, mt * 128, 0, sm);
        }
        const int lane = threadIdx.x & 63, wv = threadIdx.x >> 6;
        for (int u = blockIdx.x * 4 + wv; u < 32 * 8 * 128; u += gridDim.x * 4) attn_unit(PQKV, KMEAN, AOUT, u, lane);
    }
    grid_bar(ctr, epoch);
    { GA g{}; g.A = YMIX; g.lda = 512; g.Bt = WBP; g.K = 512; g.M = T; g.N = 1024; g.outb = MERGED; g.gate = GATES; g.goff = 0; g.add = 0; gemm_phase<3>(g, sm); }
    grid_bar(ctr, epoch);
    { GA g{}; g.A = AOUT; g.lda = 512; g.Bt = WBA; g.K = 512; g.M = T; g.N = 1024; g.outb = MERGED; g.gate = GATES; g.goff = 1024; g.add = 1; gemm_phase<3>(g, sm); }
    grid_bar(ctr, epoch);
    { GA g{}; g.A = MERGED; g.lda = 1024; g.Bt = WOUT; g.K = 1024; g.M = T; g.N = 1024; g.outf = hbuf; g.resf = hbuf; g.scale = 1.0f; gemm_phase<1>(g, sm); }
    grid_bar(ctr, epoch);
    rms_rows(hbuf, p.in[12], XN, nullptr);
    grid_bar(ctr, epoch);
    { GA g{}; g.A = XN; g.lda = 1024; g.Bt = GU2; g.K = 1024; g.M = T; g.N = 5632; g.outb = HM; gemm_phase<0>(g, sm); }
    grid_bar(ctr, epoch);
    { GA g{}; g.A = HM; g.lda = FF; g.Bt = D2; g.K = FF; g.M = T; g.N = 1024; g.outf = hbuf; g.resf = hbuf; g.scale = 0.5f; gemm_phase<1>(g, sm); }
    grid_bar(ctr, epoch);
    rms_rows(hbuf, p.in[16], nullptr, hbuf);
}

extern "C" void kernel_launch(void* const* d_in, const int* in_sizes, int n_in, void* d_out, int out_size, void* d_ws, size_t ws_size, hipStream_t stream) {
    static int grid = 0;
    if (grid == 0) {
        if (n_in != 17 || ws_size < WS_END) { fprintf(stderr, "kernel_launch: bad args n_in=%d ws=%zu need %zu\n", n_in, ws_size, (size_t)WS_END); grid = -1; return; }
        int dev = 0, cus = 0, per_cu = 0;
        (void)hipGetDevice(&dev);
        (void)hipDeviceGetAttribute(&cus, hipDeviceAttributeMultiprocessorCount, dev);
        (void)hipFuncSetAttribute((const void*)fwd, hipFuncAttributeMaxDynamicSharedMemorySize, LDS_BYTES);
        if (hipOccupancyMaxActiveBlocksPerMultiprocessor(&per_cu, (const void*)fwd, 256, LDS_BYTES) != hipSuccess || per_cu < 1) per_cu = 1;
        if (per_cu > 2) per_cu = 2;
        grid = (cus * per_cu) & ~7;
    }
    if (grid < 0) return;
    (void)hipMemsetAsync((char*)d_ws + WS_CTR, 0, 256, stream);
    Params p{};
    for (int i = 0; i < 17; ++i) p.in[i] = (const float*)d_in[i];
    p.out = (float*)d_out; p.ws = (unsigned char*)d_ws;
    hipLaunchKernelGGL(fwd, dim3(grid), dim3(256), LDS_BYTES, stream, p);
}
```

```cpp
#include <hip/hip_runtime.h>
#include <stdint.h>
#include <stdio.h>

typedef unsigned short bf16_t;
typedef short bf16x8 __attribute__((ext_vector_type(8)));
typedef float f32x4 __attribute__((ext_vector_type(4)));

constexpr int T = 65536, DM = 1024, FF = 2816, SEQ = 2048;
constexpr size_t MB = 1024 * 1024;
constexpr int LDS_BYTES = 65536;
constexpr size_t WS_CTR = 0;
constexpr size_t WS_XN = 1 * MB;
constexpr size_t WS_HM = WS_XN + (size_t)T * 1024 * 2;
constexpr size_t WS_GATES = WS_HM + (size_t)T * 2816 * 2;
constexpr size_t WS_KMEAN = WS_GATES + (size_t)T * 2048 * 2;
constexpr size_t WS_GU1 = WS_KMEAN + 1 * MB;
constexpr size_t WS_D1 = WS_GU1 + (size_t)5632 * 1024 * 2;
constexpr size_t WS_WIN = WS_D1 + (size_t)1024 * 2816 * 2;
constexpr size_t WS_POOL = WS_WIN + (size_t)4096 * 1024 * 2;
constexpr size_t WS_WBP = WS_POOL + (size_t)4 * 128 * 128 * 2;
constexpr size_t WS_WBA = WS_WBP + (size_t)1024 * 512 * 2;
constexpr size_t WS_WOUT = WS_WBA + (size_t)1024 * 512 * 2;
constexpr size_t WS_GU2 = WS_WOUT + (size_t)1024 * 1024 * 2;
constexpr size_t WS_D2 = WS_GU2 + (size_t)5632 * 1024 * 2;
constexpr size_t WS_END = WS_D2 + (size_t)1024 * 2816 * 2;

struct Params {
    const float* in[17];
    float* out;
    unsigned char* ws;
};

__device__ __forceinline__ bf16_t f2bf(float f) { unsigned u = __float_as_uint(f); u += 0x7fffu + ((u >> 16) & 1u); return (bf16_t)(u >> 16); }
__device__ __forceinline__ float bf2f(bf16_t b) { return __uint_as_float(((unsigned)b) << 16); }
__device__ __forceinline__ unsigned pack2(float a, float b) { return (unsigned)f2bf(a) | ((unsigned)f2bf(b) << 16); }

__device__ __forceinline__ void grid_bar(unsigned* ctr, unsigned& epoch) {
    asm volatile("s_waitcnt vmcnt(0)" ::: "memory");
    __syncthreads();
    epoch += gridDim.x;
    if (threadIdx.x == 0) {
        __builtin_amdgcn_fence(__ATOMIC_RELEASE, "agent");
        asm volatile("s_waitcnt vmcnt(0)" ::: "memory");
        __hip_atomic_fetch_add(ctr, 1u, __ATOMIC_RELAXED, __HIP_MEMORY_SCOPE_AGENT);
        while (__hip_atomic_load(ctr, __ATOMIC_RELAXED, __HIP_MEMORY_SCOPE_AGENT) < epoch) __builtin_amdgcn_s_sleep(2);
        __builtin_amdgcn_fence(__ATOMIC_ACQUIRE, "agent");
        asm volatile("s_waitcnt vmcnt(0)" ::: "memory");
    }
    __syncthreads();
}

__device__ void xpose(const float* W0, const float* W1, int ldw, int K, int Nout, int mode, const float* cs, bf16_t* Bt, float* tile) {
    const int tk = K / 64, tn = Nout / 64;
    const int tx = threadIdx.x & 63, ty = threadIdx.x >> 6;
    for (int t = blockIdx.x; t < tk * tn; t += gridDim.x) {
        const int k0 = (t % tk) * 64, n0 = (t / tk) * 64;
        const int np = n0 + tx; const float* W = W0; int sc = np;
        if (mode == 1) { const int b16 = np >> 4; sc = (b16 >> 1) * 16 + (np & 15); W = (b16 & 1) ? W1 : W0; }
        const float s = cs ? cs[np] : 1.f;
        for (int r = ty; r < 64; r += 4) tile[r * 65 + tx] = W[(size_t)(k0 + r) * ldw + sc] * s;
        __syncthreads();
        for (int r = ty; r < 64; r += 4) Bt[(size_t)(n0 + r) * K + k0 + tx] = f2bf(tile[tx * 65 + r]);
        __syncthreads();
    }
}

__device__ void rms_rows(const float* X, const float* gain, bf16_t* outb, float* outf) {
    const int lane = threadIdx.x & 63, wv = threadIdx.x >> 6;
    for (int row = blockIdx.x * 4 + wv; row < T; row += gridDim.x * 4) {
        const float4* xp = (const float4*)(X + (size_t)row * 1024);
        float4 v[4]; float ss = 0.f;
#pragma unroll
        for (int i = 0; i < 4; ++i) { v[i] = xp[lane + 64 * i]; ss += v[i].x * v[i].x + v[i].y * v[i].y + v[i].z * v[i].z + v[i].w * v[i].w; }
#pragma unroll
        for (int o = 1; o < 64; o <<= 1) ss += __shfl_xor(ss, o);
        const float r = rsqrtf(ss * (1.0f / 1024.0f) + 1e-6f);
#pragma unroll
        for (int i = 0; i < 4; ++i) {
            const float4 g = ((const float4*)gain)[lane + 64 * i];
            const float a = v[i].x * r * g.x, b = v[i].y * r * g.y, c = v[i].z * r * g.z, d = v[i].w * r * g.w;
            if (outb) { uint2 w; w.x = pack2(a, b); w.y = pack2(c, d); *(uint2*)(outb + (size_t)row * 1024 + (lane + 64 * i) * 4) = w; }
            else { float4 o4; o4.x = a; o4.y = b; o4.z = c; o4.w = d; ((float4*)(outf + (size_t)row * 1024))[lane + 64 * i] = o4; }
        }
    }
}

struct GA {
    const bf16_t* A; int lda; const bf16_t* Bt; int K; int M; int N;
    float* outf; const float* resf; float scale;
    bf16_t* outb; int ldc; const bf16_t* gate; int goff; int add; bf16_t* outb2;
};

template <int MODE>
__device__ __forceinline__ void gemm_tile(const GA& g, int m0, int n0, bf16_t* sm) {
    const int tid = threadIdx.x, lane = tid & 63, wave = tid >> 6, wr = wave >> 1, wc = wave & 1, fr = lane & 15, fq = lane >> 4;
    f32x4 acc[4][4];
#pragma unroll
    for (int i = 0; i < 4; ++i)
#pragma unroll
        for (int j = 0; j < 4; ++j) acc[i][j] = (f32x4){0.f, 0.f, 0.f, 0.f};
    typedef __attribute__((address_space(3))) unsigned LDSU;
    __attribute__((address_space(3))) unsigned char* lds = (__attribute__((address_space(3))) unsigned char*)sm;
    const int lr = lane >> 3, sch = (lane & 7) ^ lr;
    const bf16_t* Ap = g.A + (size_t)(m0 + wave * 32 + lr) * g.lda + sch * 8;
    const bf16_t* Bp = g.Bt + (size_t)(n0 + wave * 32 + lr) * g.K + sch * 8;
    const size_t a8 = (size_t)8 * g.lda, b8 = (size_t)8 * g.K;
    const int wbase = __builtin_amdgcn_readfirstlane(wave * 4096);
#define STAGE(bufi) do { _Pragma("unroll") for (int i_ = 0; i_ < 4; ++i_) { \
        __builtin_amdgcn_global_load_lds((const unsigned*)(Ap + i_ * a8), (LDSU*)(lds + (bufi) * 32768 + wbase + i_ * 1024), 16, 0, 0); \
        __builtin_amdgcn_global_load_lds((const unsigned*)(Bp + i_ * b8), (LDSU*)(lds + (bufi) * 32768 + 16384 + wbase + i_ * 1024), 16, 0, 0); } } while (0)
    STAGE(0);
    asm volatile("s_waitcnt vmcnt(0)" ::: "memory");
    __syncthreads();
    const unsigned char* smb = (const unsigned char*)sm;
    const int nk = g.K / 64;
    for (int kt = 0; kt < nk; ++kt) {
        const int buf = kt & 1;
        if (kt + 1 < nk) { Ap += 64; Bp += 64; if (buf) STAGE(0); else STAGE(1); }
#pragma unroll
        for (int kk = 0; kk < 2; ++kk) {
            bf16x8 af[4], bfr[4];
            const int sl = ((kk * 4 + fq) ^ (fr & 7)) * 16;
#pragma unroll
            for (int i = 0; i < 4; ++i) af[i] = *(const bf16x8*)(smb + buf * 32768 + (wr * 64 + i * 16 + fr) * 128 + sl);
#pragma unroll
            for (int j = 0; j < 4; ++j) bfr[j] = *(const bf16x8*)(smb + buf * 32768 + 16384 + (wc * 64 + j * 16 + fr) * 128 + sl);
#pragma unroll
            for (int i = 0; i < 4; ++i)
#pragma unroll
                for (int j = 0; j < 4; ++j) acc[i][j] = __builtin_amdgcn_mfma_f32_16x16x32_bf16(bfr[j], af[i], acc[i][j], 0, 0, 0);
        }
        asm volatile("s_waitcnt vmcnt(0)" ::: "memory");
        __syncthreads();
    }
#undef STAGE
#pragma unroll
    for (int i = 0; i < 4; ++i) {
        const size_t row = (size_t)(m0 + wr * 64 + i * 16 + fr);
#pragma unroll
        for (int j = 0; j < 4; ++j) {
            const int col = n0 + wc * 64 + j * 16 + 4 * fq;
            const f32x4 v = acc[i][j];
            if (MODE == 0) {
                if (j & 1) continue;
                const f32x4 u = acc[i][j | 1];
                const int hid = ((n0 + wc * 64 + j * 16) >> 5) * 16 + 4 * fq;
                float o[4];
#pragma unroll
                for (int e = 0; e < 4; ++e) o[e] = v[e] / (1.f + __expf(-v[e])) * u[e];
                uint2 w; w.x = pack2(o[0], o[1]); w.y = pack2(o[2], o[3]);
                *(uint2*)(g.outb + row * FF + hid) = w;
            } else if (MODE == 1) {
                const float4 rs = *(const float4*)(g.resf + row * 1024 + col);
                float4 o; o.x = rs.x + g.scale * v[0]; o.y = rs.y + g.scale * v[1]; o.z = rs.z + g.scale * v[2]; o.w = rs.w + g.scale * v[3];
                *(float4*)(g.outf + row * 1024 + col) = o;
            } else if (MODE == 2) {
                uint2 w;
                if (n0 < 2048) { w.x = pack2(v[0], v[1]); w.y = pack2(v[2], v[3]); *(uint2*)(g.outb + row * 2048 + col) = w; }
                else {
                    float o[4];
#pragma unroll
                    for (int e = 0; e < 4; ++e) o[e] = 1.f / (1.f + __expf(-v[e]));
                    w.x = pack2(o[0], o[1]); w.y = pack2(o[2], o[3]); *(uint2*)(g.outb2 + row * 2048 + (col - 2048)) = w;
                }
            } else if (MODE == 3) {
                const uint2 gw = *(const uint2*)(g.gate + row * 2048 + g.goff + col);
                float o[4];
                o[0] = bf2f((bf16_t)(gw.x & 0xffff)) * v[0]; o[1] = bf2f((bf16_t)(gw.x >> 16)) * v[1];
                o[2] = bf2f((bf16_t)(gw.y & 0xffff)) * v[2]; o[3] = bf2f((bf16_t)(gw.y >> 16)) * v[3];
                if (g.add) {
                    const uint2 pw = *(const uint2*)(g.outb + row * 1024 + col);
                    o[0] += bf2f((bf16_t)(pw.x & 0xffff)); o[1] += bf2f((bf16_t)(pw.x >> 16));
                    o[2] += bf2f((bf16_t)(pw.y & 0xffff)); o[3] += bf2f((bf16_t)(pw.y >> 16));
                }
                uint2 w; w.x = pack2(o[0], o[1]); w.y = pack2(o[2], o[3]);
                *(uint2*)(g.outb + row * 1024 + col) = w;
            } else {
                uint2 w; w.x = pack2(v[0], v[1]); w.y = pack2(v[2], v[3]);
                *(uint2*)(g.outb + row * g.ldc + col) = w;
            }
        }
    }
}

template <int MODE>
__device__ __forceinline__ void gemm_phase(const GA& g, bf16_t* sm) {
    const int nN = g.N / 128, nM = g.M / 128;
    const int GN = (nN % 8 == 0) ? 8 : 4, GM = 64 / GN, nGN = nN / GN, ngroups = (nM / GM) * nGN;
    const int xcd = blockIdx.x & 7, local = blockIdx.x >> 3, per = gridDim.x >> 3;
    for (int L = local;; L += per) {
        const int gidx = (L >> 6) * 8 + xcd; if (gidx >= ngroups) break;
        const int w = L & 63;
        const int mt = (gidx / nGN) * GM + (w % GM), nt = (gidx % nGN) * GN + (w / GM);
        gemm_tile<MODE>(g, mt * 128, nt * 128, sm);
    }
}

__device__ void mixed_phase(const bf16_t* pqkv, bf16_t* mixed, float* kmean) {
    const size_t total = (size_t)T * 128;
    for (size_t e = (size_t)blockIdx.x * 256 + threadIdx.x; e < total; e += (size_t)gridDim.x * 256) {
        const int c4 = (int)(e & 127) * 4; const size_t t = e >> 7; const int s = (int)(t & (SEQ - 1));
        const int w = 2 << (c4 >> 7);
        const int cnt = (s + 1 < w) ? (s + 1) : w;
        float a0 = 0.f, a1 = 0.f, a2 = 0.f, a3 = 0.f; float p0 = 0.f, p1 = 0.f, p2 = 0.f, p3 = 0.f;
#pragma unroll
        for (int j = 0; j < 16; ++j) {
            if (j >= cnt) continue;
            const uint2 pw = *(const uint2*)(pqkv + (t - j) * 2048 + c4);
            const float x0 = bf2f((bf16_t)(pw.x & 0xffff)), x1 = bf2f((bf16_t)(pw.x >> 16)), x2 = bf2f((bf16_t)(pw.y & 0xffff)), x3 = bf2f((bf16_t)(pw.y >> 16));
            if (j == 0) { p0 = x0; p1 = x1; p2 = x2; p3 = x3; }
            a0 += x0; a1 += x1; a2 += x2; a3 += x3;
        }
        const float ic = 1.f / (float)cnt;
        uint2 w2; w2.x = pack2(a0 * ic - p0, a1 * ic - p1); w2.y = pack2(a2 * ic - p2, a3 * ic - p3);
        *(uint2*)(mixed + t * 512 + c4) = w2;
    }
    const int lane = threadIdx.x & 63, wv = threadIdx.x >> 6;
    for (int u = blockIdx.x * 4 + wv; u < 32 * 8 * 8; u += gridDim.x * 4) {
        const int n = u & 7, h = (u >> 3) & 7, b = u >> 6;
        const bf16_t* kp = pqkv + ((size_t)b * SEQ + n * 256) * 2048 + 1024 + h * 64 + lane;
        float s = 0.f;
#pragma unroll 16
        for (int i = 0; i < 256; ++i) s += bf2f(kp[(size_t)i * 2048]);
        kmean[(size_t)u * 64 + lane] = s * (1.f / 256.f);
    }
}

__device__ __forceinline__ void attn_unit(const bf16_t* pqkv, const float* kmean, bf16_t* aout, int u, int lane) {
    const int qt = u & 127, bh = u >> 7, h = bh & 7, b = bh >> 3;
    const int fr = lane & 15, fq = lane >> 4;
    const int q0 = qt * 16, own = q0 >> 8, tq = q0 + fr;
    const size_t tokbase = (size_t)b * SEQ;
    const float NEG = -__builtin_inff();
    const bf16_t* qp = pqkv + (tokbase + tq) * 2048 + 512 + h * 64;
    bf16x8 qf[2];
    qf[0] = *(const bf16x8*)(qp + 8 * fq); qf[1] = *(const bf16x8*)(qp + 32 + 8 * fq);
    unsigned selmask;
    if (own <= 3) selmask = (1u << own) - 1u;
    else {
        float gt[8];
#pragma unroll
        for (int n = 0; n < 8; ++n) {
            float s = 0.f;
            if (n < own) {
                const float* km = kmean + ((size_t)bh * 8 + n) * 64 + 8 * fq;
#pragma unroll
                for (int c = 0; c < 2; ++c)
#pragma unroll
                    for (int i = 0; i < 8; ++i) s += bf2f((bf16_t)qf[c][i]) * km[32 * c + i];
            }
            s += __shfl_xor(s, 16); s += __shfl_xor(s, 32);
            gt[n] = (n < own) ? s : NEG;
        }
        selmask = 0u;
#pragma unroll
        for (int n = 0; n < 8; ++n) {
            int rank = 0;
#pragma unroll
            for (int m = 0; m < 8; ++m) if (m != n) rank += ((gt[m] > gt[n]) || (gt[m] == gt[n] && m < n)) ? 1 : 0;
            if (n < own && rank < 3) selmask |= 1u << n;
        }
    }
    const float slope = exp2f(-(float)(h + 1));
    float mrun = NEG, lsum = 0.f;
    f32x4 o[4];
#pragma unroll
    for (int d = 0; d < 4; ++d) o[d] = (f32x4){0.f, 0.f, 0.f, 0.f};
    const bf16_t* kbase_p = pqkv + tokbase * 2048 + 1024 + h * 64;
    const bf16_t* vbase_p = pqkv + tokbase * 2048 + 1536 + h * 64;
    for (int bi = 0; bi <= own; ++bi) {
        const bool is_own = (bi == 0);
        const int nblk = is_own ? own : (bi - 1);
        const bool rowsel = is_own ? true : (((selmask >> nblk) & 1u) != 0u);
        if (__ballot(rowsel) == 0ull) continue;
        const int kb0 = nblk * 256;
        const int nch = is_own ? ((q0 + 15 - kb0) / 32 + 1) : 8;
        for (int ch = 0; ch < nch; ++ch) {
            const int kb = kb0 + 32 * ch;
            f32x4 s0 = (f32x4){0.f, 0.f, 0.f, 0.f}, s1 = (f32x4){0.f, 0.f, 0.f, 0.f};
#pragma unroll
            for (int c = 0; c < 2; ++c) {
                const bf16x8 k0 = *(const bf16x8*)(kbase_p + (size_t)(kb + fr) * 2048 + 32 * c + 8 * fq);
                const bf16x8 k1 = *(const bf16x8*)(kbase_p + (size_t)(kb + 16 + fr) * 2048 + 32 * c + 8 * fq);
                s0 = __builtin_amdgcn_mfma_f32_16x16x32_bf16(k0, qf[c], s0, 0, 0, 0);
                s1 = __builtin_amdgcn_mfma_f32_16x16x32_bf16(k1, qf[c], s1, 0, 0, 0);
            }
            float p[8]; float mx = NEG;
#pragma unroll
            for (int i = 0; i < 4; ++i) {
                const int key0 = kb + 4 * fq + i, key1 = key0 + 16;
                const float v0 = s0[i] * 0.125f - slope * (float)(tq - key0);
                const float v1 = s1[i] * 0.125f - slope * (float)(tq - key1);
                p[i] = (rowsel && key0 <= tq) ? v0 : NEG;
                p[4 + i] = (rowsel && key1 <= tq) ? v1 : NEG;
                mx = fmaxf(mx, fmaxf(p[i], p[4 + i]));
            }
            mx = fmaxf(mx, __shfl_xor(mx, 16)); mx = fmaxf(mx, __shfl_xor(mx, 32));
            const float mnew = fmaxf(mrun, mx);
            const float alpha = (mrun == NEG) ? 0.f : __expf(mrun - mnew);
            float ps = 0.f;
#pragma unroll
            for (int i = 0; i < 8; ++i) { p[i] = (p[i] == NEG) ? 0.f : __expf(p[i] - mnew); ps += p[i]; }
            lsum = lsum * alpha + ps; mrun = mnew;
            bf16x8 pb;
#pragma unroll
            for (int i = 0; i < 8; ++i) pb[i] = (short)f2bf(p[i]);
#pragma unroll
            for (int d = 0; d < 4; ++d) {
                o[d] = o[d] * alpha;
                bf16x8 vf;
#pragma unroll
                for (int i = 0; i < 8; ++i) {
                    const int key = kb + ((i < 4) ? (4 * fq + i) : (16 + 4 * fq + i - 4));
                    vf[i] = (short)vbase_p[(size_t)key * 2048 + 16 * d + fr];
                }
                o[d] = __builtin_amdgcn_mfma_f32_16x16x32_bf16(vf, pb, o[d], 0, 0, 0);
            }
        }
    }
    lsum += __shfl_xor(lsum, 16); lsum += __shfl_xor(lsum, 32);
    const float il = 1.f / lsum;
#pragma unroll
    for (int d = 0; d < 4; ++d) {
        uint2 w; w.x = pack2(o[d][0] * il, o[d][1] * il); w.y = pack2(o[d][2] * il, o[d][3] * il);
        *(uint2*)(aout + (tokbase + tq) * 512 + h * 64 + 16 * d + 4 * fq) = w;
    }
}

__global__ __launch_bounds__(256) __attribute__((amdgpu_waves_per_eu(2, 2))) void fwd(Params p) {
    extern __shared__ __attribute__((aligned(16))) unsigned char smem[];
    bf16_t* sm = (bf16_t*)smem;
    unsigned char* ws = p.ws;
    unsigned* ctr = (unsigned*)(ws + WS_CTR);
    unsigned epoch = 0;
    bf16_t* XN = (bf16_t*)(ws + WS_XN);
    bf16_t* HM = (bf16_t*)(ws + WS_HM);
    bf16_t* PQKV = HM;
    bf16_t* MIXED = (bf16_t*)(ws + WS_HM + (size_t)T * 2048 * 2);
    bf16_t* MERGED = HM;
    bf16_t* YMIX = XN;
    bf16_t* AOUT = (bf16_t*)(ws + WS_XN + (size_t)T * 512 * 2);
    bf16_t* GATES = (bf16_t*)(ws + WS_GATES);
    float* KMEAN = (float*)(ws + WS_KMEAN);
    bf16_t* GU1 = (bf16_t*)(ws + WS_GU1); bf16_t* D1 = (bf16_t*)(ws + WS_D1); bf16_t* WIN = (bf16_t*)(ws + WS_WIN);
    bf16_t* POOLT = (bf16_t*)(ws + WS_POOL); bf16_t* WBP = (bf16_t*)(ws + WS_WBP); bf16_t* WBA = (bf16_t*)(ws + WS_WBA);
    bf16_t* WOUT = (bf16_t*)(ws + WS_WOUT); bf16_t* GU2 = (bf16_t*)(ws + WS_GU2); bf16_t* D2 = (bf16_t*)(ws + WS_D2);
    const float* x = p.in[0];
    float* hbuf = p.out;

    {
        float* tile = (float*)smem;
        xpose(p.in[2], p.in[3], FF, 1024, 5632, 1, nullptr, GU1, tile);
        xpose(p.in[4], nullptr, 1024, FF, 1024, 0, nullptr, D1, tile);
        xpose(p.in[6], nullptr, 4096, 1024, 4096, 0, nullptr, WIN, tile);
        for (int gi = 0; gi < 4; ++gi) xpose(p.in[7] + gi * 16384, nullptr, 128, 128, 128, 0, p.in[8] + gi * 128, POOLT + gi * 16384, tile);
        xpose(p.in[9], nullptr, 1024, 512, 1024, 0, nullptr, WBP, tile);
        xpose(p.in[10], nullptr, 1024, 512, 1024, 0, nullptr, WBA, tile);
        xpose(p.in[11], nullptr, 1024, 1024, 1024, 0, nullptr, WOUT, tile);
        xpose(p.in[13], p.in[14], FF, 1024, 5632, 1, nullptr, GU2, tile);
        xpose(p.in[15], nullptr, 1024, FF, 1024, 0, nullptr, D2, tile);
        rms_rows(x, p.in[1], XN, nullptr);
    }
    grid_bar(ctr, epoch);
    { GA g{}; g.A = XN; g.lda = 1024; g.Bt = GU1; g.K = 1024; g.M = T; g.N = 5632; g.outb = HM; gemm_phase<0>(g, sm); }
    grid_bar(ctr, epoch);
    { GA g{}; g.A = HM; g.lda = FF; g.Bt = D1; g.K = FF; g.M = T; g.N = 1024; g.outf = hbuf; g.resf = x; g.scale = 0.5f; gemm_phase<1>(g, sm); }
    grid_bar(ctr, epoch);
    rms_rows(hbuf, p.in[5], XN, nullptr);
    grid_bar(ctr, epoch);
    { GA g{}; g.A = XN; g.lda = 1024; g.Bt = WIN; g.K = 1024; g.M = T; g.N = 4096; g.outb = PQKV; g.outb2 = GATES; gemm_phase<2>(g, sm); }
    grid_bar(ctr, epoch);
    mixed_phase(PQKV, MIXED, KMEAN);
    grid_bar(ctr, epoch);
    {
        for (int t = blockIdx.x; t < 2048; t += gridDim.x) {
            const int gi = t & 3, mt = t >> 2;
            GA g{}; g.A = MIXED + gi * 128; g.lda = 512; g.Bt = POOLT + gi * 16384; g.K = 128; g.M = T; g.N = 128; g.outb = YMIX + gi * 128; g.ldc = 512;
            gemm_tile<4>(g, mt * 128, 0, sm);
        }
        const int lane = threadIdx.x & 63, wv = threadIdx.x >> 6;
        const int nw = gridDim.x * 4; int it = 0;
        for (int u = blockIdx.x * 4 + wv; u < 32 * 8 * 128; u += nw, ++it) {
            int uu = u; if ((nw & 127) == 0 && (it & 1)) uu = (u & ~127) | (127 - (u & 127));
            attn_unit(PQKV, KMEAN, AOUT, uu, lane);
        }
    }
    grid_bar(ctr, epoch);
    { GA g{}; g.A = YMIX; g.lda = 512; g.Bt = WBP; g.K = 512; g.M = T; g.N = 1024; g.outb = MERGED; g.gate = GATES; g.goff = 0; g.add = 0; gemm_phase<3>(g, sm); }
    grid_bar(ctr, epoch);
    { GA g{}; g.A = AOUT; g.lda = 512; g.Bt = WBA; g.K = 512; g.M = T; g.N = 1024; g.outb = MERGED; g.gate = GATES; g.goff = 1024; g.add = 1; gemm_phase<3>(g, sm); }
    grid_bar(ctr, epoch);
    { GA g{}; g.A = MERGED; g.lda = 1024; g.Bt = WOUT; g.K = 1024; g.M = T; g.N = 1024; g.outf = hbuf; g.resf = hbuf; g.scale = 1.0f; gemm_phase<1>(g, sm); }
    grid_bar(ctr, epoch);
    rms_rows(hbuf, p.in[12], XN, nullptr);
    grid_bar(ctr, epoch);
    { GA g{}; g.A = XN; g.lda = 1024; g.Bt = GU2; g.K = 1024; g.M = T; g.N = 5632; g.outb = HM; gemm_phase<0>(g, sm); }
    grid_bar(ctr, epoch);
    { GA g{}; g.A = HM; g.lda = FF; g.Bt = D2; g.K = FF; g.M = T; g.N = 1024; g.outf = hbuf; g.resf = hbuf; g.scale = 0.5f; gemm_phase<1>(g, sm); }
    grid_bar(ctr, epoch);
    rms_rows(hbuf, p.in[16], nullptr, hbuf);
}

extern "C" void kernel_launch(void* const* d_in, const int* in_sizes, int n_in, void* d_out, int out_size, void* d_ws, size_t ws_size, hipStream_t stream) {
    static int grid = 0;
    if (grid == 0) {
        if (n_in != 17 || ws_size < WS_END) { fprintf(stderr, "kernel_launch: bad args n_in=%d ws=%zu need %zu\n", n_in, ws_size, (size_t)WS_END); grid = -1; return; }
        int dev = 0, cus = 0, per_cu = 0;
        (void)hipGetDevice(&dev);
        (void)hipDeviceGetAttribute(&cus, hipDeviceAttributeMultiprocessorCount, dev);
        (void)hipFuncSetAttribute((const void*)fwd, hipFuncAttributeMaxDynamicSharedMemorySize, LDS_BYTES);
        if (hipOccupancyMaxActiveBlocksPerMultiprocessor(&per_cu, (const void*)fwd, 256, LDS_BYTES) != hipSuccess || per_cu < 1) per_cu = 1;
        if (per_cu > 2) per_cu = 2;
        grid = (cus * per_cu) & ~7;
    }
    if (grid < 0) return;
    (void)hipMemsetAsync((char*)d_ws + WS_CTR, 0, 256, stream);
    Params p{};
    for (int i = 0; i < 17; ++i) p.in[i] = (const float*)d_in[i];
    p.out = (float*)d_out; p.ws = (unsigned char*)d_ws;
    hipLaunchKernelGGL(fwd, dim3(grid), dim3(256), LDS_BYTES, stream, p);
}
```
